# Optimizing an MI355X kernel written in HIP

```python
import jax, jax.numpy as jnp
from jax import lax
import numpy as np

D_MODEL = 1024
BATCH = 8
SEQ = 8192
DEPTH = 1

D_FF = 2816
D_MIX = D_MODEL
N_HEADS = 8
HEAD_DIM = 64
N_KV_HEADS = 2
KV_GROUP = N_HEADS // N_KV_HEADS
D_ATTN = N_HEADS * HEAD_DIM
D_KV = N_KV_HEADS * HEAD_DIM
Q_BLOCK = 128
ROPE_THETA = 10000.0
AXIS_DIM = HEAD_DIM // 2
GRID_W = 64
N_SGU_GROUPS = 8
SGU_GROUP_DIM = 64
D_SGU = N_SGU_GROUPS * SGU_GROUP_DIM
CHUNK = 128
D_IN = D_ATTN + 2 * D_KV + 2 * D_SGU
EPS = 1e-6

kernel_name = "hybrid_macaron_gmlp_gqa_axial_encoder_block"


def rms_norm(x, g):
    xf = x.astype(jnp.float32)
    y = xf * lax.rsqrt(jnp.mean(xf * xf, axis=-1, keepdims=True) + EPS)
    return (y * g.astype(jnp.float32)).astype(x.dtype)


def swiglu(h, w_gate, w_up, w_down):
    return (jax.nn.silu(h @ w_gate) * (h @ w_up)) @ w_down


def axial_rope_tables(rows):
    row_idx = jnp.repeat(jnp.arange(rows, dtype=jnp.float32), GRID_W)
    col_idx = jnp.tile(jnp.arange(GRID_W, dtype=jnp.float32), rows)
    inv = 1.0 / (ROPE_THETA ** (jnp.arange(0, AXIS_DIM, 2, dtype=jnp.float32) / AXIS_DIM))
    ang = jnp.concatenate([row_idx[:, None] * inv, col_idx[:, None] * inv], axis=-1)
    return jnp.cos(ang), jnp.sin(ang)


def apply_rope(x, cos, sin):
    b, s, h, d = x.shape
    xf = x.astype(jnp.float32).reshape(b, s, h, d // 2, 2)
    x1, x2 = xf[..., 0], xf[..., 1]
    c = cos[None, :, None, :]
    sn = sin[None, :, None, :]
    out = jnp.stack([x1 * c - x2 * sn, x1 * sn + x2 * c], axis=-1)
    return out.reshape(b, s, h, d).astype(x.dtype)


def gqa_attention(q, k, v):
    b, s, _, d = q.shape
    nblk = s // Q_BLOCK
    scale = HEAD_DIM ** -0.5
    qb = q.reshape(b, nblk, Q_BLOCK, N_KV_HEADS, KV_GROUP, d).transpose(1, 0, 2, 3, 4, 5)

    def one_block(qi):
        sc = jnp.einsum('bqkgd,bskd->bkgqs', qi, k, preferred_element_type=jnp.float32) * scale
        p = jax.nn.softmax(sc, axis=-1)
        return jnp.einsum('bkgqs,bskd->bqkgd', p.astype(v.dtype), v)

    o = lax.map(one_block, qb)
    return o.transpose(1, 0, 2, 3, 4, 5).reshape(b, s, N_HEADS * d)


def spatial_gating(z, g_sgu, w_s, b_s):
    b, s, _ = z.shape
    u, vv = jnp.split(z, 2, axis=-1)
    vv = rms_norm(vv, g_sgu)
    vv = vv.reshape(b, s // CHUNK, CHUNK, N_SGU_GROUPS, SGU_GROUP_DIM)
    f = jnp.einsum('gpq,bnqgd->bnpgd', w_s, vv) + b_s.T[None, None, :, :, None]
    return u * f.reshape(b, s, D_SGU)


def setup_inputs(seed: int = 0) -> dict:
    key = jax.random.key(seed)
    ks = jax.random.split(key, 24)
    L = DEPTH
    nrm = lambda k, shape, fan_in: jax.random.normal(k, shape, jnp.float32) * fan_in ** -0.5
    gain = lambda k, shape: 1.0 + 0.02 * jax.random.normal(k, shape, jnp.float32)
    return {
        "x": jax.random.normal(ks[0], (BATCH, SEQ, D_MODEL), jnp.float32),
        "g_ffn1": gain(ks[1], (L, D_MODEL)),
        "w1_gate": nrm(ks[2], (L, D_MODEL, D_FF), D_MODEL),
        "w1_up": nrm(ks[3], (L, D_MODEL, D_FF), D_MODEL),
        "w1_down": nrm(ks[4], (L, D_FF, D_MODEL), D_FF),
        "g_mix": gain(ks[5], (L, D_MODEL)),
        "w_in": nrm(ks[6], (L, D_MODEL, D_IN), D_MODEL),
        "g_q": gain(ks[7], (L, HEAD_DIM)),
        "g_k": gain(ks[8], (L, HEAD_DIM)),
        "g_sgu": gain(ks[9], (L, D_SGU)),
        "w_s": nrm(ks[10], (L, N_SGU_GROUPS, CHUNK, CHUNK), CHUNK),
        "b_s": 1.0 + 0.02 * jax.random.normal(ks[11], (L, N_SGU_GROUPS, CHUNK), jnp.float32),
        "g_attn_out": gain(ks[12], (L, D_ATTN)),
        "g_sgu_out": gain(ks[13], (L, D_SGU)),
        "w_out": nrm(ks[14], (L, D_MIX, D_MODEL), D_MIX),
        "g_ffn2": gain(ks[15], (L, D_MODEL)),
        "w2_gate": nrm(ks[16], (L, D_MODEL, D_FF), D_MODEL),
        "w2_up": nrm(ks[17], (L, D_MODEL, D_FF), D_MODEL),
        "w2_down": nrm(ks[18], (L, D_FF, D_MODEL), D_FF),
        "g_final": gain(ks[19], (L, D_MODEL)),
    }


def reference(x, g_ffn1, w1_gate, w1_up, w1_down, g_mix, w_in, g_q, g_k, g_sgu, w_s, b_s,
              g_attn_out, g_sgu_out, w_out, g_ffn2, w2_gate, w2_up, w2_down, g_final):
    b, s, _ = x.shape
    rows = s // GRID_W
    cos, sin = axial_rope_tables(rows)
    for l in range(DEPTH):
        x = x + 0.5 * swiglu(rms_norm(x, g_ffn1[l]), w1_gate[l], w1_up[l], w1_down[l])

        h = rms_norm(x, g_mix[l])
        proj = h @ w_in[l]
        q, k, v, z = jnp.split(proj, [D_ATTN, D_ATTN + D_KV, D_ATTN + 2 * D_KV], axis=-1)

        q = rms_norm(q.reshape(b, s, N_HEADS, HEAD_DIM), g_q[l])
        k = rms_norm(k.reshape(b, s, N_KV_HEADS, HEAD_DIM), g_k[l])
        v = v.reshape(b, s, N_KV_HEADS, HEAD_DIM)
        q = apply_rope(q, cos, sin)
        k = apply_rope(k, cos, sin)
        attn = gqa_attention(q, k, v)

        sgu = spatial_gating(jax.nn.gelu(z), g_sgu[l], w_s[l], b_s[l])

        mixed = jnp.concatenate([rms_norm(attn, g_attn_out[l]), rms_norm(sgu, g_sgu_out[l])], axis=-1)
        x = x + mixed @ w_out[l]

        x = x + 0.5 * swiglu(rms_norm(x, g_ffn2[l]), w2_gate[l], w2_up[l], w2_down[l])
        x = rms_norm(x, g_final[l])
    return x
```

```cpp
#include <hip/hip_runtime.h>
#include <cstdio>
#include <cstdint>
namespace pg8 {
#define PG8_LAS __attribute__((address_space(3)))
typedef unsigned short bf16_t;
typedef short bf16x8 __attribute__((ext_vector_type(8)));
typedef float f32x4 __attribute__((ext_vector_type(4)));
typedef unsigned u32x4 __attribute__((ext_vector_type(4)));
constexpr int BM = 256, BK = 64, HALF = 128, HTB = HALF * BK * 2  , STAGE_BYTES = 8 * HTB, NXCD = 8, WGM = 8;

__host__ __device__ __forceinline__ int lds_byte(int r, int c) { const int st = (r >> 4) * 2 + (c >> 5), rr = r & 15, cc = c & 31, ob = rr * 64 + cc * 2; return st * 1024 + (ob ^ (((ob >> 9) & 1) << 5)); }
__host__ __device__ __forceinline__ void stage_rc(int b, int& R, int& C) { const int st = b / 1024, sb = b % 1024, swz = sb ^ (((sb >> 9) & 1) << 5); R = (st >> 1) * 16 + swz / 64; C = (st & 1) * 32 + (swz % 64) / 2; }
__host__ __device__ __forceinline__ int perm32(int rho) { const int n = rho >> 4, i = rho & 15; return 8 * (i >> 2) + 4 * n + (i & 3); }

struct Unit { int pm, pn; };
struct Gemm { const bf16_t* A; const bf16_t* Bt; int M, N, K; };

struct StaticOrder {
    int nM, nN, nwg, G, c;
    __host__ __device__ void init(int M, int N, int G_, int c_) { nM = M / BM; nN = N / BM; nwg = nM * nN; G = G_; c = c_; }
    __host__ __device__ bool next(int i, Unit& u) const {
        const long L = (long)i * G + c; if (L >= nwg) return false;
        int wgid = (int)L; { const int q = nwg / NXCD, r = nwg % NXCD, xcd = wgid % NXCD, off = wgid / NXCD; wgid = (xcd < r ? xcd * (q + 1) : r * (q + 1) + (xcd - r) * q) + off; }
        const int nig = WGM * nN, gid = wgid / nig, fm = gid * WGM, gsz = (nM - fm) < WGM ? (nM - fm) : WGM;
        u.pm = fm + ((wgid % nig) % gsz); u.pn = (wgid % nig) / gsz; return true;
    }
    __device__ __forceinline__ void a_ready(const Unit&) const {}
    __device__ __forceinline__ void done(const Unit&) const {}
};

__device__ __forceinline__ unsigned cvt_pk_bf16(float lo, float hi) { unsigned r; asm volatile("v_cvt_pk_bf16_f32 %0, %1, %2" : "=v"(r) : "v"(lo), "v"(hi)); return r; }
constexpr float RMS_EPS = 1e-6f;
__device__ __forceinline__ float row_rstd16(const float* part, int row, int fq, float invn) {
    const f32x4 p = *(const f32x4*)(part + (size_t)row * 16 + 4 * fq);
    float s = (p[0] + p[1]) + (p[2] + p[3]);
    s += __shfl_xor(s, 16); s += __shfl_xor(s, 32);
    return __builtin_amdgcn_rsqf(s * invn + RMS_EPS);
}
__device__ __forceinline__ float silu_f(float g) { return g * __builtin_amdgcn_rcpf(1.0f + __builtin_amdgcn_exp2f(-1.4426950408889634f * g)); }
__device__ __forceinline__ float gelu_f(float x) { const float u = x * (0.7978845608028654f + 0.035677408136300125f * x * x);
    return x * __builtin_amdgcn_rcpf(1.0f + __builtin_amdgcn_exp2f(-2.8853900817779268f * u)); }
__device__ __forceinline__ float sq4(const f32x4 v) { return (v[0] * v[0] + v[1] * v[1]) + (v[2] * v[2] + v[3] * v[3]); }
__device__ __forceinline__ u32x4 pack8(const f32x4 a, const f32x4 b) { u32x4 w; w.x = cvt_pk_bf16(a[0], a[1]); w.y = cvt_pk_bf16(a[2], a[3]); w.z = cvt_pk_bf16(b[0], b[1]); w.w = cvt_pk_bf16(b[2], b[3]); return w; }

struct EpiSwiGLU {
    static constexpr bool PERM = true, AFTER_DRAIN = false;
    bf16_t* H; int ldh; const float* part;
    __device__ __forceinline__ void operator()(const f32x4 (&acc)[2][2][4][2], const Unit& u, int wr, int wc, int fr_, int fq_) const {
        int fr = fr_, fq = fq_; asm volatile("" : "+v"(fr), "+v"(fq));
        const int row0 = u.pm * BM + wr * 64 + fr, col0 = u.pn * HALF + wc * 32 + 8 * fq;
#pragma unroll
        for (int ai = 0; ai < 2; ++ai)
#pragma unroll
            for (int m = 0; m < 4; ++m) { const int row = row0 + ai * HALF + m * 16; const float rs = row_rstd16(part, row, fq, 1.0f / 1024.0f);
                f32x4 h[2];
#pragma unroll
                for (int n = 0; n < 2; ++n) { const f32x4 g = acc[ai][0][m][n] * rs, up = acc[ai][1][m][n] * rs;
#pragma unroll
                    for (int j = 0; j < 4; ++j) h[n][j] = silu_f(g[j]) * up[j]; }
                *(u32x4*)(H + (size_t)row * ldh + col0) = pack8(h[0], h[1]); }
    }
};
struct EpiRes {
    static constexpr bool PERM = true, AFTER_DRAIN = false;
    const float* base; float* out; bf16_t* xn; const float* gain; float* part; float alpha;
    __device__ __forceinline__ void operator()(const f32x4 (&acc)[2][2][4][2], const Unit& u, int wr, int wc, int fr_, int fq_) const {
        int fr = fr_, fq = fq_; asm volatile("" : "+v"(fr), "+v"(fq));
        const int row0 = u.pm * BM + wr * 64 + fr, col0 = u.pn * BM + wc * 32 + 8 * fq;
#pragma unroll
        for (int ai = 0; ai < 2; ++ai)
#pragma unroll
            for (int m = 0; m < 4; ++m) { const int row = row0 + ai * HALF + m * 16; float ss = 0.f;
#pragma unroll
                for (int bj = 0; bj < 2; ++bj) { const size_t off = (size_t)row * 1024 + col0 + bj * HALF;
                    const f32x4 b0 = *(const f32x4*)(base + off), b1 = *(const f32x4*)(base + off + 4);
                    const f32x4 v0 = b0 + acc[ai][bj][m][0] * alpha, v1 = b1 + acc[ai][bj][m][1] * alpha;
                    *(f32x4*)(out + off) = v0; *(f32x4*)(out + off + 4) = v1; ss += sq4(v0) + sq4(v1);
                    if (xn) { const f32x4 g0 = *(const f32x4*)(gain + col0 + bj * HALF), g1 = *(const f32x4*)(gain + col0 + bj * HALF + 4);
                        *(u32x4*)(xn + off) = pack8(v0 * g0, v1 * g1); } }
                ss += __shfl_xor(ss, 16); ss += __shfl_xor(ss, 32);
                if (fq == 0) part[(size_t)row * 16 + u.pn * 4 + wc] = ss; }
    }
};
struct EpiWin {
    static constexpr bool PERM = true, AFTER_DRAIN = false;
    bf16_t *Q, *K, *V, *U, *VV; const float *part, *g_q, *g_k, *g_sgu; float* partv;
    __device__ __forceinline__ void operator()(const f32x4 (&acc)[2][2][4][2], const Unit& u, int wr, int wc, int fr_, int fq_) const {
        int fr = fr_, fq = fq_; asm volatile("" : "+v"(fr), "+v"(fq));
        const int pn = u.pn, row0 = u.pm * BM + wr * 64 + fr;
        if (pn < 2 || (pn == 2 && wc < 2)) {
            const bool isq = pn < 2; const float* gg = isq ? g_q : g_k;
            f32x4 gv[2][2]; float invf[2][2];
#pragma unroll
            for (int bj = 0; bj < 2; ++bj)
#pragma unroll
                for (int n = 0; n < 2; ++n) gv[bj][n] = *(const f32x4*)(gg + 32 * bj + 8 * fq + 4 * n);
#pragma unroll
            for (int n = 0; n < 2; ++n)
#pragma unroll
                for (int jp = 0; jp < 2; ++jp) invf[n][jp] = __builtin_amdgcn_exp2f(-0.8304820237218406f * (float)(4 * fq + 2 * n + jp)) * 0.15915494309189535f;
            const float qs = isq ? 0.125f * 1.4426950408889634f : 1.0f;
#pragma unroll
            for (int ai = 0; ai < 2; ++ai)
#pragma unroll
                for (int m = 0; m < 4; ++m) { const int row = row0 + ai * HALF + m * 16; const float rs = row_rstd16(part, row, fq, 1.0f / 1024.0f);
                    f32x4 v[2][2]; float ss = 0.f;
#pragma unroll
                    for (int bj = 0; bj < 2; ++bj)
#pragma unroll
                        for (int n = 0; n < 2; ++n) { v[bj][n] = acc[ai][bj][m][n] * rs; ss += sq4(v[bj][n]); }
                    ss += __shfl_xor(ss, 16); ss += __shfl_xor(ss, 32);
                    const float rq = __builtin_amdgcn_rsqf(ss * (1.0f / 64.0f) + RMS_EPS) * qs;
                    const int t = row & 8191, b = row >> 13;
#pragma unroll
                    for (int bj = 0; bj < 2; ++bj) { const float pos = (float)(bj == 0 ? (t >> 6) : (t & 63));
#pragma unroll
                        for (int n = 0; n < 2; ++n) { const f32x4 x = v[bj][n] * rq * gv[bj][n]; f32x4 o;
#pragma unroll
                            for (int jp = 0; jp < 2; ++jp) { const float a = __builtin_amdgcn_fractf(pos * invf[n][jp]);
                                const float sn = __builtin_amdgcn_sinf(a), cs = __builtin_amdgcn_cosf(a);
                                o[2 * jp] = x[2 * jp] * cs - x[2 * jp + 1] * sn; o[2 * jp + 1] = x[2 * jp] * sn + x[2 * jp + 1] * cs; }
                            v[bj][n] = o; }
                        bf16_t* dst = isq ? Q + (size_t)row * 512 + (4 * pn + wc) * 64 + 32 * bj + 8 * fq
                                          : K + ((size_t)(b * 2 + wc) * 8192 + t) * 64 + 32 * bj + 8 * fq;
                        *(u32x4*)dst = pack8(v[bj][0], v[bj][1]); } }
        } else if (pn == 2) {
#pragma unroll
            for (int ai = 0; ai < 2; ++ai)
#pragma unroll
                for (int m = 0; m < 4; ++m) { const int row = row0 + ai * HALF + m * 16; const float rs = row_rstd16(part, row, fq, 1.0f / 1024.0f);
                    const int t = row & 8191, b = row >> 13;
#pragma unroll
                    for (int bj = 0; bj < 2; ++bj)
                        *(u32x4*)(V + ((size_t)(b * 2 + (wc - 2)) * 8192 + t) * 64 + 32 * bj + 8 * fq) = pack8(acc[ai][bj][m][0] * rs, acc[ai][bj][m][1] * rs); }
        } else if (pn < 5) {
            const int c0 = (pn - 3) * 256 + 64 * wc + 8 * fq;
#pragma unroll
            for (int ai = 0; ai < 2; ++ai)
#pragma unroll
                for (int m = 0; m < 4; ++m) { const int row = row0 + ai * HALF + m * 16; const float rs = row_rstd16(part, row, fq, 1.0f / 1024.0f);
#pragma unroll
                    for (int bj = 0; bj < 2; ++bj) { f32x4 z[2];
#pragma unroll
                        for (int n = 0; n < 2; ++n)
#pragma unroll
                            for (int j = 0; j < 4; ++j) z[n][j] = gelu_f(acc[ai][bj][m][n][j] * rs);
                        *(u32x4*)(U + (size_t)row * 512 + c0 + 32 * bj) = pack8(z[0], z[1]); } }
        } else {
            const int c0 = (pn - 5) * 256 + 64 * wc + 8 * fq;
            f32x4 gs[2][2];
#pragma unroll
            for (int bj = 0; bj < 2; ++bj)
#pragma unroll
                for (int n = 0; n < 2; ++n) gs[bj][n] = *(const f32x4*)(g_sgu + c0 + 32 * bj + 4 * n);
#pragma unroll
            for (int ai = 0; ai < 2; ++ai)
#pragma unroll
                for (int m = 0; m < 4; ++m) { const int row = row0 + ai * HALF + m * 16; const float rs = row_rstd16(part, row, fq, 1.0f / 1024.0f); float ss = 0.f;
#pragma unroll
                    for (int bj = 0; bj < 2; ++bj) { f32x4 z[2];
#pragma unroll
                        for (int n = 0; n < 2; ++n) {
#pragma unroll
                            for (int j = 0; j < 4; ++j) z[n][j] = gelu_f(acc[ai][bj][m][n][j] * rs);
                            ss += sq4(z[n]); }
                        *(u32x4*)(VV + (size_t)row * 512 + c0 + 32 * bj) = pack8(z[0] * gs[bj][0], z[1] * gs[bj][1]); }
                    ss += __shfl_xor(ss, 16); ss += __shfl_xor(ss, 32);
                    if (fq == 0) partv[(size_t)row * 8 + (pn - 5) * 4 + wc] = ss; }
        }
    }
};

template <class Epi, class Sched, bool ALIGN_EPI = false, bool SP2 = false>
__device__ __forceinline__ void gemm_phase(PG8_LAS unsigned char* lds, const Gemm g, const Sched& S, const Epi& E) {
    const int tid = threadIdx.x, wid = __builtin_amdgcn_readfirstlane(tid >> 6), lane = tid & 63, wr = wid >> 2, wc = wid & 3, fr = lane & 15, fq = lane >> 4;
    const int K = g.K, nt = K / BK;
    unsigned voffA[2], voffB[2];
#pragma unroll
    for (int i = 0; i < 2; ++i) { int R, C; stage_rc(tid * 16 + i * 8192, R, C); const int Rb = Epi::PERM ? ((R & ~31) + perm32(R & 31)) : R;
        voffA[i] = (unsigned)(R * K + C) * 2u; voffB[i] = (unsigned)(Rb * K + C) * 2u; }
    const size_t kstep = (size_t)(BK * 2);
    const size_t hstep = (size_t)HALF * K * 2;
    const size_t tstep = 2 * hstep;
    const unsigned ldsw = (unsigned)wid * 1024u;
    const int aoff = lds_byte(wr * 64 + fr, fq * 8), boff = lds_byte(wc * 32 + fr, fq * 8);
#define PG8_SA(b, h) (((b) * 2 + (h)) * HTB)
#define PG8_SB(b, h) ((4 + (b) * 2 + (h)) * HTB)
#define PG8_STAGE(bufoff, gbase, voff) do { _Pragma("unroll") for (int _i = 0; _i < 2; ++_i) \
        __builtin_amdgcn_global_load_lds((const unsigned*)((const char*)(gbase) + (voff)[_i]), (PG8_LAS unsigned*)(lds + (bufoff) + ldsw + _i * 8192), 16, 0, 0); } while (0)
#define PG8_LDA(dst, b, h) do { _Pragma("unroll") for (int m = 0; m < 4; ++m) _Pragma("unroll") for (int k = 0; k < 2; ++k) dst[m][k] = *(const PG8_LAS bf16x8*)(lds + PG8_SA(b, h) + aoff + m * 2048 + k * 1024); } while (0)
#define PG8_LDB(dst, b, h) do { _Pragma("unroll") for (int n = 0; n < 2; ++n) _Pragma("unroll") for (int k = 0; k < 2; ++k) dst[n][k] = *(const PG8_LAS bf16x8*)(lds + PG8_SB(b, h) + boff + n * 2048 + k * 1024); } while (0)
#define PG8_MMA(ai, bj, At, Bt) do { __builtin_amdgcn_s_setprio(1); _Pragma("unroll") for (int m = 0; m < 4; ++m) _Pragma("unroll") for (int n = 0; n < 2; ++n) _Pragma("unroll") for (int k = 0; k < 2; ++k) \
        acc[ai][bj][m][n] = __builtin_amdgcn_mfma_f32_16x16x32_bf16(Bt[n][k], At[m][k], acc[ai][bj][m][n], 0, 0, 0); __builtin_amdgcn_s_setprio(0); } while (0)
#define PG8_WAIT_V(n) asm volatile("s_waitcnt vmcnt(" #n ")" ::: "memory")
#define PG8_WAIT_L(n) asm volatile("s_waitcnt lgkmcnt(" #n ")" ::: "memory")
#define PG8_BAR __builtin_amdgcn_s_barrier()
#define PG8_SCHED __builtin_amdgcn_sched_barrier(0)
    Unit cur, nxt; int ui = 0;
    if (!S.next(0, cur)) return;
    f32x4 acc[2][2][4][2];
#pragma unroll
    for (int a = 0; a < 2; ++a)
#pragma unroll
        for (int b = 0; b < 2; ++b)
#pragma unroll
            for (int m = 0; m < 4; ++m)
#pragma unroll
                for (int n = 0; n < 2; ++n) acc[a][b][m][n] = (f32x4){0.f, 0.f, 0.f, 0.f};
    bf16x8 At[4][2], B0[2][2], B1[2][2];
    const char* cA = (const char*)g.A + (size_t)cur.pm * tstep; const char* cB = (const char*)g.Bt + (size_t)cur.pn * tstep;
    S.a_ready(cur);
    if constexpr (SP2) {
        PG8_STAGE(PG8_SB(0, 0), cB, voffB); PG8_STAGE(PG8_SB(0, 1), cB + hstep, voffB); PG8_STAGE(PG8_SA(0, 0), cA, voffA); PG8_STAGE(PG8_SA(0, 1), cA + hstep, voffA);
        if (wr == 1) PG8_BAR;
        PG8_WAIT_V(2); PG8_BAR;
        PG8_STAGE(PG8_SB(1, 0), cB + kstep, voffB); PG8_STAGE(PG8_SA(1, 0), cA + kstep, voffA); PG8_STAGE(PG8_SB(1, 1), cB + hstep + kstep, voffB);
        PG8_WAIT_V(6); PG8_BAR;
    } else {
        PG8_STAGE(PG8_SB(0, 0), cB, voffB); PG8_STAGE(PG8_SA(0, 0), cA, voffA); PG8_STAGE(PG8_SB(0, 1), cB + hstep, voffB); PG8_STAGE(PG8_SA(0, 1), cA + hstep, voffA);
        if (wr == 1) PG8_BAR;
        PG8_WAIT_V(4); PG8_BAR;
        PG8_STAGE(PG8_SB(1, 0), cB + kstep, voffB); PG8_STAGE(PG8_SA(1, 0), cA + kstep, voffA); PG8_STAGE(PG8_SB(1, 1), cB + hstep + kstep, voffB);
        PG8_WAIT_V(6); PG8_BAR;
    }
    for (;;) {
        const bool has_next = S.next(ui + 1, nxt);
        const char* nA = has_next ? (const char*)g.A + (size_t)nxt.pm * tstep : cA; const char* nB = has_next ? (const char*)g.Bt + (size_t)nxt.pn * tstep : cB;
        for (int t = 0; t < nt; t += 2) {
            const bool last = (t == nt - 2);
            const char* a1 = cA + (size_t)(t + 1) * kstep;
            const char* a2 = last ? nA : cA + (size_t)(t + 2) * kstep; const char* b2 = last ? nB : cB + (size_t)(t + 2) * kstep;
            const char* a3 = a2 + kstep; const char* b3 = b2 + kstep;
            if (last && has_next) S.a_ready(nxt);
            if constexpr (SP2) {
            PG8_LDB(B0, 0, 0); PG8_LDB(B1, 0, 1); PG8_SCHED; PG8_LDA(At, 0, 0); PG8_STAGE(PG8_SA(1, 1), a1 + hstep, voffA);
            PG8_WAIT_V(8); PG8_WAIT_L(0); PG8_BAR; PG8_MMA(0, 0, At, B0); PG8_MMA(0, 1, At, B1); PG8_BAR; PG8_SCHED;
            PG8_LDA(At, 0, 1); PG8_STAGE(PG8_SB(0, 0), b2, voffB); PG8_STAGE(PG8_SB(0, 1), b2 + hstep, voffB); PG8_STAGE(PG8_SA(0, 0), a2, voffA);
            PG8_WAIT_V(8); PG8_WAIT_L(0); PG8_BAR; PG8_MMA(1, 0, At, B0); PG8_MMA(1, 1, At, B1); PG8_BAR; PG8_SCHED;
            PG8_LDB(B0, 1, 0); PG8_LDB(B1, 1, 1); PG8_SCHED; PG8_LDA(At, 1, 0); PG8_STAGE(PG8_SA(0, 1), a2 + hstep, voffA);
            PG8_WAIT_V(8); PG8_WAIT_L(0); PG8_BAR; PG8_MMA(0, 0, At, B0); PG8_MMA(0, 1, At, B1); PG8_BAR; PG8_SCHED;
            PG8_LDA(At, 1, 1); PG8_STAGE(PG8_SB(1, 0), b3, voffB); PG8_STAGE(PG8_SB(1, 1), b3 + hstep, voffB); PG8_STAGE(PG8_SA(1, 0), a3, voffA);
            PG8_WAIT_V(8); PG8_WAIT_L(0); PG8_BAR; PG8_MMA(1, 0, At, B0); PG8_MMA(1, 1, At, B1); PG8_BAR; PG8_SCHED;
            } else {
            PG8_LDB(B0, 0, 0); PG8_SCHED; PG8_LDA(At, 0, 0); PG8_STAGE(PG8_SA(1, 1), a1 + hstep, voffA);
            PG8_WAIT_L(8); PG8_BAR; PG8_WAIT_L(0); PG8_MMA(0, 0, At, B0); PG8_BAR; PG8_SCHED;
            PG8_LDB(B1, 0, 1); PG8_STAGE(PG8_SB(0, 0), b2, voffB);
            PG8_BAR; PG8_WAIT_L(0); PG8_MMA(0, 1, At, B1); PG8_BAR;
            PG8_LDA(At, 0, 1); PG8_STAGE(PG8_SA(0, 0), a2, voffA);
            PG8_BAR; PG8_WAIT_L(0); PG8_MMA(1, 0, At, B0); PG8_BAR; PG8_SCHED;
            PG8_STAGE(PG8_SB(0, 1), b2 + hstep, voffB);
            PG8_WAIT_V(6); PG8_BAR; PG8_MMA(1, 1, At, B1); PG8_BAR;
            PG8_LDB(B0, 1, 0); PG8_SCHED; PG8_LDA(At, 1, 0); PG8_STAGE(PG8_SA(0, 1), a2 + hstep, voffA);
            PG8_WAIT_L(8); PG8_BAR; PG8_WAIT_L(0); PG8_MMA(0, 0, At, B0); PG8_BAR; PG8_SCHED;
            PG8_LDB(B1, 1, 1); PG8_STAGE(PG8_SB(1, 0), b3, voffB);
            PG8_BAR; PG8_WAIT_L(0); PG8_MMA(0, 1, At, B1); PG8_BAR;
            PG8_LDA(At, 1, 1); PG8_STAGE(PG8_SA(1, 0), a3, voffA);
            PG8_BAR; PG8_WAIT_L(0); PG8_MMA(1, 0, At, B0); PG8_BAR; PG8_SCHED;
            PG8_STAGE(PG8_SB(1, 1), b3 + hstep, voffB);
            PG8_WAIT_V(6); PG8_BAR; PG8_MMA(1, 1, At, B1); PG8_BAR;
            }
        }
        if constexpr (ALIGN_EPI) { if (wr == 0) PG8_BAR; }
        if constexpr (!Epi::AFTER_DRAIN) { E(acc, cur, wr, wc, fr, fq); S.done(cur); }
        if (!has_next) break;
#pragma unroll
        for (int a = 0; a < 2; ++a)
#pragma unroll
            for (int b = 0; b < 2; ++b)
#pragma unroll
                for (int m = 0; m < 4; ++m)
#pragma unroll
                    for (int n = 0; n < 2; ++n) acc[a][b][m][n] = (f32x4){0.f, 0.f, 0.f, 0.f};
        cur = nxt; cA = nA; cB = nB; ++ui;
        if constexpr (ALIGN_EPI) { if (wr == 1) PG8_BAR; }
    }
    PG8_WAIT_V(0);
    if constexpr (!ALIGN_EPI) { if (wr == 0) PG8_BAR; }
    PG8_BAR;
    if constexpr (Epi::AFTER_DRAIN) { E.fused(acc, cur, wr, wc, fr, fq, lds, wid, lane); S.done(cur); }
#undef PG8_SA
#undef PG8_SB
#undef PG8_STAGE
#undef PG8_LDA
#undef PG8_LDB
#undef PG8_MMA
#undef PG8_WAIT_V
#undef PG8_WAIT_L
#undef PG8_BAR
#undef PG8_SCHED
}
}

#ifndef PG8_SP2
#define PG8_SP2 true
#endif
#ifndef PG8_ALIGN
#define PG8_ALIGN true
#endif
#include <hip/hip_bf16.h>
#include <cmath>
namespace attn_body {
using bf16=__hip_bfloat16;
using bf16x8=__attribute__((ext_vector_type(8)))short;
using s16x4=__attribute__((ext_vector_type(4)))short;
using f32x16=__attribute__((ext_vector_type(16)))float;
using u32x4=__attribute__((ext_vector_type(4)))unsigned;
constexpr int BATCH=8,NHEAD=8,NKVH=2,SEQ=8192,D=64,QP=512,KVP=64,OP=1024;
constexpr int NW=8,QBLK=32,QB=QBLK*NW,KVBLK=64,NQB=SEQ/QB;
constexpr int ATTN_UNIT_ROWS=QB;
__device__ __forceinline__ int crow(int r,int hi){return (r&3)+8*(r>>2)+4*hi;}
#define SBAR() __builtin_amdgcn_sched_barrier(0)
__device__ __forceinline__ void cmask(f32x16&p0,f32x16&p1,int jb,int qrel,int hi){
  const float NEG=-INFINITY; int kb=64*jb+4*hi;
  #pragma unroll
  for(int r=0;r<16;++r){int kv=kb+(r&3)+8*(r>>2); if(kv>qrel)p0[r]=NEG; if(kv+32>qrel)p1[r]=NEG;}
}

constexpr int NSLOT=3, SLOTB=8192;
constexpr int LDS_K=0, LDS_V=NSLOT*SLOTB, LDS_WS=2*NSLOT*SLOTB, LDS_OST=LDS_WS+NW*64*4, LDS_SS=LDS_OST+NW*4096, LDS_BYTES=LDS_SS+NW*32*4;
constexpr float C2=0.125f*1.4426950408889634f;
__device__ __forceinline__ void glds16(const void*gsrc,unsigned lds_dst){unsigned keep;
  asm volatile("s_mov_b32 %0, m0\n\ts_mov_b32 m0, %2\n\ts_nop 0\n\tglobal_load_lds_dwordx4 %1, off\n\ts_mov_b32 m0, %0":"=&s"(keep):"v"(gsrc),"s"(lds_dst):"memory");}
__device__ __forceinline__ float max3f(float a,float b,float c){float r;asm("v_max3_f32 %0, %1, %2, %3":"=v"(r):"v"(a),"v"(b),"v"(c));return r;}
__device__ __forceinline__ float max2f(float a,float b){float r;asm("v_max_f32_e32 %0, %1, %2":"=v"(r):"v"(a),"v"(b));return r;}
__device__ __forceinline__ float fadd_s(float a,float b){float r;asm("v_add_f32_e32 %0, %1, %2":"=v"(r):"v"(a),"v"(b));return r;}
__device__ __forceinline__ float fsub_s(float a,float b){float r;asm("v_sub_f32_e32 %0, %1, %2":"=v"(r):"v"(a),"v"(b));return r;}
typedef float f32x2_t __attribute__((ext_vector_type(2))); typedef __bf16 bf16x2_t __attribute__((ext_vector_type(2)));
__device__ __forceinline__ unsigned cvtpk_s(float lo,float hi){f32x2_t v={lo,hi};bf16x2_t b=__builtin_convertvector(v,bf16x2_t);return __builtin_bit_cast(unsigned,b);}
#define WAIT_BAR(N) asm volatile("s_waitcnt vmcnt(" #N ") lgkmcnt(0)\n\ts_barrier":::"memory")

__device__ __forceinline__ void qkt(f32x16&p0,f32x16&p1,const char*Kslot,const bf16x8*qr,const f32x16&negm,int r32,int hi){
  const char*kb=Kslot+hi*1024+r32*16;
  #pragma unroll
  for(int d0=0;d0<4;++d0){
    const bf16x8 b0=*reinterpret_cast<const bf16x8*>(kb+d0*2048);
    const bf16x8 b1=*reinterpret_cast<const bf16x8*>(kb+d0*2048+512);
    if(d0==0){p0=__builtin_amdgcn_mfma_f32_32x32x16_bf16(b0,qr[0],negm,0,0,0);p1=__builtin_amdgcn_mfma_f32_32x32x16_bf16(b1,qr[0],negm,0,0,0);}
    else{p0=__builtin_amdgcn_mfma_f32_32x32x16_bf16(b0,qr[d0],p0,0,0,0);p1=__builtin_amdgcn_mfma_f32_32x32x16_bf16(b1,qr[d0],p1,0,0,0);}}
}
typedef __attribute__((address_space(3))) const char* lds_cptr;
typedef short v4i16_t __attribute__((ext_vector_type(4)));
__device__ __forceinline__ void kload8(bf16x8*kf,lds_cptr kp){
  kf[0]=*(const __attribute__((address_space(3))) bf16x8*)(kp);      kf[1]=*(const __attribute__((address_space(3))) bf16x8*)(kp+512);
  kf[2]=*(const __attribute__((address_space(3))) bf16x8*)(kp+2048); kf[3]=*(const __attribute__((address_space(3))) bf16x8*)(kp+2560);
  kf[4]=*(const __attribute__((address_space(3))) bf16x8*)(kp+4096); kf[5]=*(const __attribute__((address_space(3))) bf16x8*)(kp+4608);
  kf[6]=*(const __attribute__((address_space(3))) bf16x8*)(kp+6144); kf[7]=*(const __attribute__((address_space(3))) bf16x8*)(kp+6656);
}
__device__ __forceinline__ void kload2(bf16x8*kf,lds_cptr kp,int j){ kf[2*j]=*(const __attribute__((address_space(3))) bf16x8*)(kp+j*2048); kf[2*j+1]=*(const __attribute__((address_space(3))) bf16x8*)(kp+j*2048+512); }
__device__ __forceinline__ s16x4 vtr(lds_cptr p){ return __builtin_bit_cast(s16x4,__builtin_amdgcn_ds_read_tr16_b64_v4i16((__attribute__((address_space(3))) v4i16_t*)p)); }
__device__ __forceinline__ float rowmax(const f32x16&p0,const f32x16&p1){
  float a=max3f(p0[0],p0[1],p1[0]),b=max3f(p0[2],p0[3],p1[1]);a=max3f(a,p1[2],p1[3]);
  #pragma unroll
  for(int r=4;r<16;r+=4){a=max3f(a,p0[r],p0[r+1]);b=max3f(b,p0[r+2],p0[r+3]);a=max3f(a,p1[r],p1[r+1]);b=max3f(b,p1[r+2],p1[r+3]);}
  const float m=max2f(a,b);
  auto rr=__builtin_amdgcn_permlane32_swap(__float_as_uint(m),__float_as_uint(m),false,false);
  return max2f(__uint_as_float(rr[0]),__uint_as_float(rr[1]));
}
__device__ __forceinline__ void pv(f32x16*o,int vb,bf16x8 pa0,bf16x8 pa1,bf16x8 pa2,bf16x8 pa3){
  #pragma unroll
  for(int d0=0;d0<2;++d0){s16x4 lo[4],hi[4];
    #pragma unroll
    for(int ks=0;ks<4;++ks){
      asm volatile("ds_read_b64_tr_b16 %0,%1 offset:%c2":"=&v"(lo[ks]):"v"(vb),"i"(d0*4096+ks*1024):"memory");
      asm volatile("ds_read_b64_tr_b16 %0,%1 offset:%c2":"=&v"(hi[ks]):"v"(vb),"i"(d0*4096+ks*1024+512):"memory");}
    asm volatile("s_waitcnt lgkmcnt(0)":::"memory");SBAR();
    #define PK(k) (bf16x8){lo[k][0],lo[k][1],lo[k][2],lo[k][3],hi[k][0],hi[k][1],hi[k][2],hi[k][3]}
    o[d0]=__builtin_amdgcn_mfma_f32_32x32x16_bf16(pa0,PK(0),o[d0],0,0,0);
    o[d0]=__builtin_amdgcn_mfma_f32_32x32x16_bf16(pa1,PK(1),o[d0],0,0,0);
    o[d0]=__builtin_amdgcn_mfma_f32_32x32x16_bf16(pa2,PK(2),o[d0],0,0,0);
    o[d0]=__builtin_amdgcn_mfma_f32_32x32x16_bf16(pa3,PK(3),o[d0],0,0,0);
    #undef PK
  }
}

#ifndef ATTN_STORE16
#define ATTN_STORE16(p,v) (*(u32x4*)(p)=(v))
#endif
template<int THRL> __device__ __forceinline__ void attn_unit(int b,int h,int qb,const bf16*Q,const bf16*__restrict__ K,const bf16*__restrict__ V,bf16*O,char*shm){
  const int tid=threadIdx.x,lane=tid&63,r32=lane&31,hi=lane>>5; const int wid=__builtin_amdgcn_readfirstlane(tid>>6);
  const long rowbase=(long)b*SEQ; const int q0=qb*QB;
  const bf16*Qw=Q+(rowbase+q0+wid*QBLK)*QP+h*D;
  const long kvbase=((long)(b*NKVH+(h>>2))*SEQ)*KVP; const bf16*Kh=K+kvbase,*Vh=V+kvbase;
  const unsigned lds0=(unsigned)(uintptr_t)shm;
  float*wsf=(float*)(shm+LDS_WS)+wid*64;
  const bf16*ksrc=Kh+(long)lane*KVP+wid*8;
  const bf16*vsrc=Vh+(long)(16*(wid&3)+(lane>>2))*KVP+(wid>>2)*32+(lane&3)*8;
  const unsigned kdst=lds0+LDS_K+wid*1024, vdst=lds0+LDS_V+wid*1024;
  #define DMA_K(t,slot) glds16(ksrc+(long)(t)*KVBLK*KVP,(unsigned)__builtin_amdgcn_readfirstlane(kdst+(slot)))
  #define DMA_V(t,slot) glds16(vsrc+(long)(t)*KVBLK*KVP,(unsigned)__builtin_amdgcn_readfirstlane(vdst+(slot)))
  const int vb0=(int)(lds0+LDS_V)+((lane>>4)&1)*32+(lane&3)*8+(4*hi+((lane&15)>>2))*64;
  const char*Kbase=shm+LDS_K; bf16x8 kf[8];
  const lds_cptr shm3=(lds_cptr)shm; const lds_cptr kp0=shm3+LDS_K+hi*1024+r32*16; const lds_cptr vp0=shm3+LDS_V+((lane>>4)&1)*32+(lane&3)*8+(4*hi+((lane&15)>>2))*64;
  const int NT=SEQ/KVBLK;
  DMA_K(0,0);DMA_V(0,0);DMA_K(1,SLOTB);
  bf16x8 qr[4];
  #pragma unroll
  for(int d0=0;d0<4;++d0)qr[d0]=*reinterpret_cast<const bf16x8*>(&Qw[(long)r32*QP+d0*16+hi*8]);
  float mhat=0.f,l_reg=0.f;f32x16 o[2];o[0]=f32x16{};o[1]=f32x16{};f32x16 negm=f32x16{};asm volatile("":"+v"(negm));
  const int qrel=wid*QBLK+r32;
  #define CMASK(P0,P1,t) do{}while(0)
  bool resc=false;
  #define START(P0,P1) do{ const float rm=rowmax(P0,P1); resc=false; \
    { const float dl=rm; mhat=fadd_s(mhat,dl); \
      _Pragma("unroll") for(int r=0;r<16;++r){P0[r]=fsub_s(P0[r],dl);P1[r]=fsub_s(P1[r],dl);} \
      _Pragma("unroll") for(int r=0;r<16;++r)negm[r]=-mhat; asm volatile("":"+v"(negm)); } \
    _Pragma("unroll") for(int r=0;r<16;++r)P0[r]=__builtin_amdgcn_exp2f(P0[r]); }while(0)
  #define RESC() do{ if(resc){ asm volatile("s_waitcnt lgkmcnt(0)":::"memory"); \
      _Pragma("unroll") for(int d_=0;d_<2;++d_) _Pragma("unroll") for(int r=0;r<16;++r)o[d_][r]*=wsf[crow(r,hi)]; } }while(0)
  f32x16 pA0,pA1,pB0,pB1;
  int sl_prev=0,sl_cur=0,sl_next=SLOTB;
  #define ROT() do{sl_prev=sl_cur;sl_cur=sl_next;sl_next=(sl_next==(NSLOT-1)*SLOTB)?0:sl_next+SLOTB;}while(0)
  DMA_K(2,2*SLOTB);
  WAIT_BAR(3);
  qkt(pA0,pA1,Kbase,qr,negm,r32,hi);asm volatile("s_nop 15\n\ts_nop 7":"+v"(pA0),"+v"(pA1));CMASK(pA0,pA1,0);
  START(pA0,pA1);
  _Pragma("unroll") for(int r=0;r<16;++r)pA1[r]=__builtin_amdgcn_exp2f(pA1[r]);
  WAIT_BAR(0);
  DMA_K(3,0);DMA_V(1,SLOTB);
  ROT();
  kload8(kf,kp0+sl_cur);
  WAIT_BAR(2);
  s16x4 vlo[8],vhi[8]; u32x4 pw0,pw1,pw2,pw3;
  #define PKW(P,B) cvtpk_s(P[B],P[B+1])
  #define PAF(k) __builtin_bit_cast(bf16x8,pw##k)
  #define VFR(i) (bf16x8){vlo[i][0],vlo[i][1],vlo[i][2],vlo[i][3],vhi[i][0],vhi[i][1],vhi[i][2],vhi[i][3]}
  #define PIN(x) asm volatile("":"+v"(x))
  #define MX3(a,b,c) __builtin_fmaxf(__builtin_fmaxf((a),(b)),(c))
  #define GAPA(MF,A0,A1,A2,A3,W0,W1,PW) do{ MF; sacc+=A0; sacc+=A1; sacc+=A2; sacc+=A3; PIN(sacc); W0; W1; PIN(PW); SBAR(); }while(0)
  #define EX(v) __builtin_amdgcn_exp2f(v)
  #define GAPB(MF,X,B) do{ MF; X[B]=EX(X[B]); X[B+1]=EX(X[B+1]); X[B+2]=EX(X[B+2]); X[B+3]=EX(X[B+3]); PIN(X); SBAR(); }while(0)
  #define VRD(i) do{ vlo[i]=vtr(vp_+(((i)>>2)*4096+((i)&3)*1024)); vhi[i]=vtr(vp_+(((i)>>2)*4096+((i)&3)*1024+512)); }while(0)
  #define KRD(G,j) do{ if(G){ kload2(kf,kp0+sl_next,j); SBAR(); } }while(0)
  #define STEP(C0,C1,P0,P1,t,GK,GV,GL) do{ SBAR(); \
    const lds_cptr vp_=vp0+sl_prev; \
    VRD(0); SBAR(); float sacc=(P0[0]+P0[1]); \
    GAPA(C0=__builtin_amdgcn_mfma_f32_32x32x16_bf16(kf[0],qr[0],negm,0,0,0), P0[2],P0[3],P0[4],P0[5],     pw0[0]=PKW(P0,0), pw0[1]=PKW(P0,2), pw0); \
    VRD(4); SBAR(); GAPA(C1=__builtin_amdgcn_mfma_f32_32x32x16_bf16(kf[1],qr[0],negm,0,0,0), P0[6],P0[7],P0[8],P0[9],     pw0[2]=PKW(P0,4), pw0[3]=PKW(P0,6), pw0); \
    VRD(1); SBAR(); GAPA(C0=__builtin_amdgcn_mfma_f32_32x32x16_bf16(kf[2],qr[1],C0,0,0,0),   P0[10],P0[11],P0[12],P0[13], pw1[0]=PKW(P0,8), pw1[1]=PKW(P0,10), pw1); \
    VRD(5); SBAR(); GAPA(C1=__builtin_amdgcn_mfma_f32_32x32x16_bf16(kf[3],qr[1],C1,0,0,0),   P0[14],P0[15],P1[0],P1[1],   pw1[2]=PKW(P0,12),pw1[3]=PKW(P0,14), pw1); \
    VRD(2); SBAR(); GAPA(C0=__builtin_amdgcn_mfma_f32_32x32x16_bf16(kf[4],qr[2],C0,0,0,0),   P1[2],P1[3],P1[4],P1[5],     pw2[0]=PKW(P1,0), pw2[1]=PKW(P1,2), pw2); \
    VRD(6); SBAR(); GAPA(C1=__builtin_amdgcn_mfma_f32_32x32x16_bf16(kf[5],qr[2],C1,0,0,0),   P1[6],P1[7],P1[8],P1[9],     pw2[2]=PKW(P1,4), pw2[3]=PKW(P1,6), pw2); \
    VRD(3); SBAR(); GAPA(C0=__builtin_amdgcn_mfma_f32_32x32x16_bf16(kf[6],qr[3],C0,0,0,0),   P1[10],P1[11],P1[12],P1[13], pw3[0]=PKW(P1,8), pw3[1]=PKW(P1,10), pw3); \
    VRD(7); SBAR(); GAPA(C1=__builtin_amdgcn_mfma_f32_32x32x16_bf16(kf[7],qr[3],C1,0,0,0),   P1[14],P1[15],0.f,0.f,       pw3[2]=PKW(P1,12),pw3[3]=PKW(P1,14), pw3); \
    l_reg+=sacc; \
    if(GK){DMA_K((t)+3,sl_cur);} if(GV){DMA_V((t)+1,sl_next);} \
    CMASK(C0,C1,t); \
    { float a=MX3(C0[0],C0[1],C1[0]),b=MX3(C0[2],C0[3],C1[1]); a=MX3(a,C1[2],C1[3]); \
      _Pragma("unroll") for(int r=4;r<16;r+=4){a=MX3(a,C0[r],C0[r+1]);b=MX3(b,C0[r+2],C0[r+3]);a=MX3(a,C1[r],C1[r+1]);b=MX3(b,C1[r+2],C1[r+3]);} \
      float rm=__builtin_fmaxf(a,b); { auto rr=__builtin_amdgcn_permlane32_swap(__float_as_uint(rm),__float_as_uint(rm),false,false); rm=__builtin_fmaxf(__uint_as_float(rr[0]),__uint_as_float(rr[1])); } \
      resc=false; \
      if(__builtin_expect(__any(rm>(float)THRL),0)){ const float dl=__builtin_fmaxf(rm,0.f); mhat+=dl; \
        _Pragma("unroll") for(int r=0;r<16;++r){C0[r]-=dl;C1[r]-=dl;} \
        _Pragma("unroll") for(int r=0;r<16;++r)negm[r]=-mhat; asm volatile("":"+v"(negm)); \
        const float f=__builtin_amdgcn_exp2f(-dl); l_reg*=f; if(hi==0)wsf[r32]=f; resc=true; } } \
    SBAR(); \
    GAPB(o[0]=__builtin_amdgcn_mfma_f32_32x32x16_bf16(PAF(0),VFR(0),o[0],0,0,0), C0,0); \
    GAPB(o[1]=__builtin_amdgcn_mfma_f32_32x32x16_bf16(PAF(0),VFR(4),o[1],0,0,0), C0,4); \
    KRD(GL,0); GAPB(o[0]=__builtin_amdgcn_mfma_f32_32x32x16_bf16(PAF(1),VFR(1),o[0],0,0,0), C0,8); \
    KRD(GL,1); GAPB(o[1]=__builtin_amdgcn_mfma_f32_32x32x16_bf16(PAF(1),VFR(5),o[1],0,0,0), C0,12); \
    KRD(GL,2); GAPB(o[0]=__builtin_amdgcn_mfma_f32_32x32x16_bf16(PAF(2),VFR(2),o[0],0,0,0), C1,0); \
    KRD(GL,3); GAPB(o[1]=__builtin_amdgcn_mfma_f32_32x32x16_bf16(PAF(2),VFR(6),o[1],0,0,0), C1,4); \
    GAPB(o[0]=__builtin_amdgcn_mfma_f32_32x32x16_bf16(PAF(3),VFR(3),o[0],0,0,0), C1,8); \
    GAPB(o[1]=__builtin_amdgcn_mfma_f32_32x32x16_bf16(PAF(3),VFR(7),o[1],0,0,0), C1,12); \
    }while(0)
  int t=1;
  #undef CMASK
  #define CMASK(P0,P1,t) do{}while(0)
  for(;t+5<NT;t+=2){
    STEP(pB0,pB1,pA0,pA1,t,true,true,true);     WAIT_BAR(2); RESC(); ROT();
    STEP(pA0,pA1,pB0,pB1,t+1,true,true,true);   WAIT_BAR(2); RESC(); ROT();
  }
  #undef CMASK
  #define CMASK(P0,P1,t) do{}while(0)
  #define ENDW(tt) do{ if((tt)+3<NT){WAIT_BAR(2);} else if((tt)+2<NT){WAIT_BAR(1);} else {WAIT_BAR(0);} }while(0)
  for(;t+1<NT;t+=2){
    STEP(pB0,pB1,pA0,pA1,t,(t+3<NT),(t+1<NT),(t+1<NT));       ENDW(t);   RESC(); ROT();
    STEP(pA0,pA1,pB0,pB1,t+1,(t+4<NT),(t+2<NT),(t+2<NT));     ENDW(t+1); RESC(); ROT();
  }
  STEP(pB0,pB1,pA0,pA1,NT-1,false,false,false); RESC();
  { float sacc=pB0[0]+pB0[1]; _Pragma("unroll") for(int r=2;r<16;++r)sacc+=pB0[r]; _Pragma("unroll") for(int r=0;r<16;++r)sacc+=pB1[r]; l_reg+=sacc;
    pw0=(u32x4){PKW(pB0,0),PKW(pB0,2),PKW(pB0,4),PKW(pB0,6)};pw1=(u32x4){PKW(pB0,8),PKW(pB0,10),PKW(pB0,12),PKW(pB0,14)};pw2=(u32x4){PKW(pB1,0),PKW(pB1,2),PKW(pB1,4),PKW(pB1,6)};pw3=(u32x4){PKW(pB1,8),PKW(pB1,10),PKW(pB1,12),PKW(pB1,14)};
    SBAR(); pv(o,vb0+sl_cur,PAF(0),PAF(1),PAF(2),PAF(3)); }
  #undef PKW
  #undef PAF
  #undef VFR
  #undef PIN
  #undef MX3
  #undef GAPA
  #undef GAPB
  #undef EX
  #undef VRD
  #undef KRD
  #undef STEP
  #undef ENDW
  {auto rr=__builtin_amdgcn_permlane32_swap(__float_as_uint(l_reg),__float_as_uint(l_reg),false,false);l_reg=__uint_as_float(rr[0])+__uint_as_float(rr[1]);}
  if(hi==0)wsf[32+r32]=l_reg;asm volatile("s_waitcnt lgkmcnt(0)":::"memory");
  float rli[16];
  #pragma unroll
  for(int r=0;r<16;++r)rli[r]=__builtin_amdgcn_rcpf(wsf[32+crow(r,hi)]);
  bf16*Ow=O+(rowbase+q0+wid*QBLK)*OP+h*D; float*ssw=(float*)(shm+LDS_SS)+wid*32;
  { bf16*stg=(bf16*)(shm+LDS_OST)+wid*2048;
    #pragma unroll
    for(int r=0;r<16;++r){const int orow=crow(r,hi);
      #pragma unroll
      for(int d0=0;d0<2;++d0)stg[orow*64+d0*32+r32]=__float2bfloat16(o[d0][r]*rli[r]);}
    asm volatile("s_waitcnt lgkmcnt(0)":::"memory");
    #pragma unroll
    for(int i=0;i<4;++i){const int row=i*8+(lane>>3),ch=lane&7; const u32x4 v=*(const u32x4*)(stg+row*64+ch*8); ATTN_STORE16(Ow+(long)row*OP+ch*8,v);
      float s_=0.f;
      #pragma unroll
      for(int w_=0;w_<4;++w_){const float lo_=__uint_as_float(v[w_]<<16),hi_=__uint_as_float(v[w_]&0xffff0000u); s_+=lo_*lo_+hi_*hi_;}
      s_+=__shfl_xor(s_,1); s_+=__shfl_xor(s_,2); s_+=__shfl_xor(s_,4); if(ch==0)ssw[row]+=s_; } }
  asm volatile("s_waitcnt lgkmcnt(0)\n\ts_barrier":::"memory");
  #undef DMA_K
  #undef DMA_V
  #undef CMASK
  #undef START
  #undef RESC
  #undef ROT
}
constexpr int ATTN_LDS_BYTES=LDS_BYTES;
#undef SBAR
#undef WAIT_BAR
}
#include <hip/hip_cooperative_groups.h>
namespace cg = cooperative_groups;
constexpr int NWAVES = 8;
#ifndef MK_N_LAUNCHES
#define MK_N_LAUNCHES 9
#endif
constexpr int N_PHASES = 9;
constexpr int N_LAUNCHES = MK_N_LAUNCHES;

constexpr int M = 65536, D = 1024, FF = 2816, DIN = 1792;
constexpr size_t MiB = 1u << 20;
constexpr size_t WS_W1GU = 2 * MiB, WS_W1D = 13 * MiB, WS_WIN = 19 * MiB, WS_WOUT = 23 * MiB, WS_W2GU = 25 * MiB, WS_W2D = 36 * MiB, WS_WS = 42 * MiB;
constexpr size_t WS_P0 = 44 * MiB, WS_P1 = 48 * MiB, WS_P2 = 52 * MiB, WS_P3 = 56 * MiB, WS_PV = 60 * MiB;
constexpr size_t WS_XN = 64 * MiB, WS_H = 192 * MiB;
constexpr size_t WS_Q = 192 * MiB, WS_K = 256 * MiB, WS_V = 272 * MiB, WS_U = 288 * MiB, WS_VV = 352 * MiB, WS_MIX = 416 * MiB, WS_END = 544 * MiB;
static_assert(WS_H + (size_t)M * FF * 2 == WS_END && WS_MIX + (size_t)M * 1024 * 2 == WS_END, "d_ws map");

constexpr int RING_OFF = 0, RING_BYTES = 131072, LDS_BYTES = 147456;

#define GAS __attribute__((address_space(1)))
#define LAS __attribute__((address_space(3)))
typedef unsigned short bf16_t;
typedef unsigned v4u __attribute__((ext_vector_type(4)));
typedef unsigned v2u __attribute__((ext_vector_type(2)));
typedef float f32x4 __attribute__((ext_vector_type(4)));
typedef short bf16x8 __attribute__((ext_vector_type(8)));
#define LDS_WAIT() asm volatile("s_waitcnt lgkmcnt(0)" ::: "memory")
__device__ __forceinline__ unsigned f2bf(float f) { unsigned u = __builtin_bit_cast(unsigned, f); return (u + 0x7fffu + ((u >> 16) & 1u)) >> 16; }
__device__ __forceinline__ unsigned pk2(float lo, float hi) { return f2bf(lo) | (f2bf(hi) << 16); }
__device__ __forceinline__ float bflo(unsigned w) { return __uint_as_float(w << 16); }
__device__ __forceinline__ float bfhi(unsigned w) { return __uint_as_float(w & 0xffff0000u); }
__device__ __forceinline__ float wave_sum(float v) {
#pragma unroll
    for (int o = 1; o < 64; o <<= 1) v += __shfl_xor(v, o);
    return v;
}
__device__ __forceinline__ int map_row(int mode, int n) {
    if (mode == 1) return (n >> 7) * 256 + (n & 127);
    if (mode == 2) return (n >> 7) * 256 + 128 + (n & 127);
    if (mode == 3) { const int a = n & 255; return (n & ~255) + 128 * ((a >> 5) & 1) + 32 * (a >> 6) + (a & 31); }
    return n;
}
__device__ __forceinline__ void p0_transpose_item(const float* W, int K, int N, bf16_t* WT, int mode, LAS float* scr, int item, int lane) {
    const int nblk = N / 32, kb = item / nblk, nb = item % nblk, k0 = 64 * kb, n0 = 32 * nb, r0 = map_row(mode, n0);
#pragma unroll 8
    for (int i = 0; i < 32; ++i) { const int kk = 2 * i + (lane >> 5); scr[kk * 33 + (lane & 31)] = W[(size_t)(k0 + kk) * N + n0 + (lane & 31)]; }
    LDS_WAIT(); asm volatile("" ::: "memory");
    const int c = lane & 7;
#pragma unroll
    for (int j = 0; j < 4; ++j) { const int n = (lane >> 3) + 8 * j; const LAS float* s = scr + (8 * c) * 33 + n;
        v4u o; o.x = pk2(s[0 * 33], s[1 * 33]); o.y = pk2(s[2 * 33], s[3 * 33]); o.z = pk2(s[4 * 33], s[5 * 33]); o.w = pk2(s[6 * 33], s[7 * 33]);
        *(GAS v4u*)(WT + (size_t)(r0 + n) * K + k0 + 8 * c) = o; }
    LDS_WAIT(); asm volatile("" ::: "memory");
}

struct Args { const float* in[20]; float* out; unsigned char* ws; int ph_lo, ph_hi; };

__global__ void __launch_bounds__(NWAVES * 64, 2) mk_fwd(Args args) {
    extern __shared__ __attribute__((aligned(16))) unsigned char lds[];
    LAS unsigned char* const ldsl = (LAS unsigned char*)lds;
    const int tid = threadIdx.x, lane = tid & 63, wave = __builtin_amdgcn_readfirstlane(tid >> 6);
    const int G = gridDim.x; const int bx = blockIdx.x; const int vcu = (G % 8 == 0) ? (bx % 8) * (G / 8) + bx / 8 : bx;
    unsigned char* ws = args.ws;
    const float* x = args.in[0]; const float* g_ffn1 = args.in[1]; const float* w1_gate = args.in[2]; const float* w1_up = args.in[3]; const float* w1_down = args.in[4];
    const float* g_mix = args.in[5]; const float* w_in = args.in[6]; const float* g_q = args.in[7]; const float* g_k = args.in[8]; const float* g_sgu = args.in[9];
    const float* w_s = args.in[10]; const float* b_s = args.in[11]; const float* g_attn_out = args.in[12]; const float* g_sgu_out = args.in[13]; const float* w_out = args.in[14];
    const float* g_ffn2 = args.in[15]; const float* w2_gate = args.in[16]; const float* w2_up = args.in[17]; const float* w2_down = args.in[18]; const float* g_final = args.in[19];
    float* out = args.out;
    bf16_t* W1GU = (bf16_t*)(ws + WS_W1GU); bf16_t* W1D = (bf16_t*)(ws + WS_W1D); bf16_t* WIN = (bf16_t*)(ws + WS_WIN); bf16_t* WOUT = (bf16_t*)(ws + WS_WOUT);
    bf16_t* W2GU = (bf16_t*)(ws + WS_W2GU); bf16_t* W2D = (bf16_t*)(ws + WS_W2D); bf16_t* WSB = (bf16_t*)(ws + WS_WS);
    float* P0 = (float*)(ws + WS_P0); float* P1 = (float*)(ws + WS_P1); float* P2 = (float*)(ws + WS_P2); float* P3 = (float*)(ws + WS_P3); float* PV = (float*)(ws + WS_PV);
    bf16_t* XN = (bf16_t*)(ws + WS_XN); bf16_t* Hg = (bf16_t*)(ws + WS_H);
    bf16_t* Qg = (bf16_t*)(ws + WS_Q); bf16_t* Kg = (bf16_t*)(ws + WS_K); bf16_t* Vg = (bf16_t*)(ws + WS_V); bf16_t* Ug = (bf16_t*)(ws + WS_U); bf16_t* VVg = (bf16_t*)(ws + WS_VV); bf16_t* MIX = (bf16_t*)(ws + WS_MIX);

    const int lo = args.ph_lo, hi = args.ph_hi;
#define IN(k) (lo <= (k) && (k) < hi)
#define SEAM(k) do { if (IN(k) && IN((k) + 1)) cg::this_grid().sync(); } while (0)
    const int gw = vcu * NWAVES + wave, NGW = G * NWAVES;

    if (IN(0)) {
        LAS float* scr = (LAS float*)(ldsl + RING_OFF + wave * 16384);
        constexpr int I_GU = (D / 64) * (FF / 32), I_D = (FF / 64) * (D / 32), I_IN = (D / 64) * (DIN / 32), I_OUT = (D / 64) * (D / 32);
        constexpr int NITEMS = 4 * I_GU + 2 * I_D + I_IN + I_OUT;
        for (int it = gw; it < NITEMS; it += NGW) {
            int r = it;
            if (r < I_GU) { p0_transpose_item(w1_gate, D, FF, W1GU, 1, scr, r, lane); continue; } r -= I_GU;
            if (r < I_GU) { p0_transpose_item(w1_up, D, FF, W1GU, 2, scr, r, lane); continue; } r -= I_GU;
            if (r < I_GU) { p0_transpose_item(w2_gate, D, FF, W2GU, 1, scr, r, lane); continue; } r -= I_GU;
            if (r < I_GU) { p0_transpose_item(w2_up, D, FF, W2GU, 2, scr, r, lane); continue; } r -= I_GU;
            if (r < I_D) { p0_transpose_item(w1_down, FF, D, W1D, 0, scr, r, lane); continue; } r -= I_D;
            if (r < I_D) { p0_transpose_item(w2_down, FF, D, W2D, 0, scr, r, lane); continue; } r -= I_D;
            if (r < I_IN) { p0_transpose_item(w_in, D, DIN, WIN, 3, scr, r, lane); continue; } r -= I_IN;
            p0_transpose_item(w_out, D, D, WOUT, 0, scr, r, lane);
        }
        for (int i = (vcu * 512 + tid) * 4; i < 8 * 128 * 128; i += G * 512 * 4) { const f32x4 v = *(const f32x4*)(w_s + i); v2u o; o.x = pk2(v[0], v[1]); o.y = pk2(v[2], v[3]); *(v2u*)(WSB + i) = o; }
        f32x4 gg[4];
#pragma unroll
        for (int j = 0; j < 4; ++j) gg[j] = *((const f32x4*)g_ffn1 + lane + 64 * j);
        for (int m = gw; m < M; m += NGW) {
            const f32x4* xr = (const f32x4*)(x + (size_t)m * D) + lane; f32x4 v[4]; float s = 0.f;
#pragma unroll
            for (int j = 0; j < 4; ++j) { v[j] = xr[64 * j]; s += pg8::sq4(v[j]); }
            s = wave_sum(s);
            v2u* o8 = (v2u*)(XN + (size_t)m * D) + lane;
#pragma unroll
            for (int j = 0; j < 4; ++j) { const f32x4 t = v[j] * gg[j]; v2u o; o.x = pk2(t[0], t[1]); o.y = pk2(t[2], t[3]); o8[64 * j] = o; }
            if (lane < 16) P0[(size_t)m * 16 + lane] = lane == 0 ? s : 0.f;
        }
    }
    SEAM(0);
    if (IN(1)) {
        pg8::Gemm g{XN, W1GU, M, 2 * FF, D}; pg8::StaticOrder S; S.init(M, 2 * FF, G, bx);
        pg8::EpiSwiGLU E{Hg, FF, P0};
        pg8::gemm_phase<pg8::EpiSwiGLU, pg8::StaticOrder, PG8_ALIGN, PG8_SP2>(ldsl + RING_OFF, g, S, E);
    }
    SEAM(1);
    if (IN(2)) {
        pg8::Gemm g{Hg, W1D, M, D, FF}; pg8::StaticOrder S; S.init(M, D, G, bx);
        pg8::EpiRes E{x, out, XN, g_mix, P1, 0.5f};
        pg8::gemm_phase<pg8::EpiRes, pg8::StaticOrder, PG8_ALIGN, PG8_SP2>(ldsl + RING_OFF, g, S, E);
    }
    SEAM(2);
    if (IN(3)) {
        pg8::Gemm g{XN, WIN, M, DIN, D}; pg8::StaticOrder S; S.init(M, DIN, G, bx);
        pg8::EpiWin E{Qg, Kg, Vg, Ug, VVg, P1, g_q, g_k, g_sgu, PV};
        pg8::gemm_phase<pg8::EpiWin, pg8::StaticOrder, PG8_ALIGN, PG8_SP2>(ldsl + RING_OFF, g, S, E);
    }
    SEAM(3);
    if (IN(4)) {
        namespace ab = attn_body;
        static_assert(ab::ATTN_LDS_BYTES <= RING_BYTES, "attention LDS");
        char* shm = (char*)lds + RING_OFF;
        for (int un = vcu; un < ab::BATCH * ab::NQB; un += G) {
            const int b = un / ab::NQB, qb = un % ab::NQB;
            float* ssw = (float*)(shm + ab::LDS_SS) + wave * 32;
            if (lane < 32) ssw[lane] = 0.f;
            LDS_WAIT();
            for (int h = 0; h < ab::NHEAD; ++h)
                ab::attn_unit<8>(b, h, qb, (const ab::bf16*)Qg, (const ab::bf16*)Kg, (const ab::bf16*)Vg, (ab::bf16*)MIX, shm);
            float rs[4];
#pragma unroll
            for (int i = 0; i < 4; ++i) rs[i] = __builtin_amdgcn_rsqf(ssw[i * 8 + (lane >> 3)] * (1.0f / 512.0f) + pg8::RMS_EPS);
            const int ch = lane & 7;
            bf16_t* Ob = MIX + ((size_t)b * ab::SEQ + qb * ab::QB + wave * ab::QBLK) * ab::OP + ch * 8;
            for (int h = 0; h < ab::NHEAD; ++h) {
                const f32x4 g0 = *(const f32x4*)(g_attn_out + h * 64 + ch * 8), g1 = *(const f32x4*)(g_attn_out + h * 64 + ch * 8 + 4);
#pragma unroll
                for (int i = 0; i < 4; ++i) { v4u* p = (v4u*)(Ob + (size_t)(i * 8 + (lane >> 3)) * ab::OP + h * 64); const v4u v = *p; const float r = rs[i]; v4u o;
                    o.x = pk2(bflo(v.x) * r * g0[0], bfhi(v.x) * r * g0[1]); o.y = pk2(bflo(v.y) * r * g0[2], bfhi(v.y) * r * g0[3]);
                    o.z = pk2(bflo(v.z) * r * g1[0], bfhi(v.z) * r * g1[1]); o.w = pk2(bflo(v.w) * r * g1[2], bfhi(v.w) * r * g1[3]); *p = o; }
            }
            __syncthreads();
        }
        for (int cnk = vcu; cnk < M / 128; cnk += G) {
            const size_t r0 = (size_t)cnk * 128;
            __syncthreads();
            for (int it = 0; it < 16; ++it) { const int id = it * 512 + tid, q = id >> 6, cc = id & 63;
                const f32x4 pa = *(const f32x4*)(PV + (r0 + q) * 8), pb = *(const f32x4*)(PV + (r0 + q) * 8 + 4);
                const float r = __builtin_amdgcn_rsqf((((pa[0] + pa[1]) + (pa[2] + pa[3])) + ((pb[0] + pb[1]) + (pb[2] + pb[3]))) * (1.0f / 512.0f) + pg8::RMS_EPS);
                const v4u v = *(const v4u*)(VVg + (r0 + q) * 512 + cc * 8); v4u o;
                o.x = pk2(bflo(v.x) * r, bfhi(v.x) * r); o.y = pk2(bflo(v.y) * r, bfhi(v.y) * r); o.z = pk2(bflo(v.z) * r, bfhi(v.z) * r); o.w = pk2(bflo(v.w) * r, bfhi(v.w) * r);
                *(LAS v4u*)(ldsl + RING_OFF + q * 1024 + ((cc * 16) ^ (((q >> 3) & 3) << 5))) = o; }
            __syncthreads();
            const int fr = lane & 15, fq = lane >> 4; const size_t row = r0 + 16 * wave + fr;
            f32x4 o[8][4]; float ss = 0.f;
#pragma unroll
            for (int g = 0; g < 8; ++g) {
                f32x4 acc[4];
#pragma unroll
                for (int nb = 0; nb < 4; ++nb) acc[nb] = (f32x4){0.f, 0.f, 0.f, 0.f};
#pragma unroll
                for (int ks = 0; ks < 4; ++ks) {
                    const bf16x8 wf = *(const bf16x8*)(WSB + ((size_t)(g * 128 + 16 * wave + fr)) * 128 + ks * 32 + fq * 8);
#pragma unroll
                    for (int nb = 0; nb < 4; ++nb) { bf16x8 vf;
#pragma unroll
                        for (int j = 0; j < 8; ++j) vf[j] = *(const LAS short*)(ldsl + RING_OFF + (ks * 32 + fq * 8 + j) * 1024 + (((g * 64 + nb * 16 + fr) * 2) ^ (fq << 5)));
                        acc[nb] = __builtin_amdgcn_mfma_f32_16x16x32_bf16(vf, wf, acc[nb], 0, 0, 0); }
                }
                const float bias = b_s[g * 128 + 16 * wave + fr];
#pragma unroll
                for (int nb = 0; nb < 4; ++nb) { const v2u uu = *(const v2u*)(Ug + row * 512 + g * 64 + nb * 16 + 4 * fq);
                    f32x4 t; t[0] = bflo(uu.x) * (acc[nb][0] + bias); t[1] = bfhi(uu.x) * (acc[nb][1] + bias); t[2] = bflo(uu.y) * (acc[nb][2] + bias); t[3] = bfhi(uu.y) * (acc[nb][3] + bias);
                    o[g][nb] = t; ss += pg8::sq4(t); }
            }
            ss += __shfl_xor(ss, 16); ss += __shfl_xor(ss, 32);
            const float r = __builtin_amdgcn_rsqf(ss * (1.0f / 512.0f) + pg8::RMS_EPS);
#pragma unroll
            for (int g = 0; g < 8; ++g)
#pragma unroll
                for (int nb = 0; nb < 4; ++nb) { const int c = g * 64 + nb * 16 + 4 * fq; const f32x4 gg = *(const f32x4*)(g_sgu_out + c); const f32x4 t = o[g][nb] * r * gg;
                    v2u w; w.x = pk2(t[0], t[1]); w.y = pk2(t[2], t[3]); *(v2u*)(MIX + row * 1024 + 512 + c) = w; }
        }
        __syncthreads();
    }
    SEAM(4);
    if (IN(5)) {
        pg8::Gemm g{MIX, WOUT, M, D, D}; pg8::StaticOrder S; S.init(M, D, G, bx);
        pg8::EpiRes E{out, out, XN, g_ffn2, P2, 1.0f};
        pg8::gemm_phase<pg8::EpiRes, pg8::StaticOrder, PG8_ALIGN, PG8_SP2>(ldsl + RING_OFF, g, S, E);
    }
    SEAM(5);
    if (IN(6)) {
        pg8::Gemm g{XN, W2GU, M, 2 * FF, D}; pg8::StaticOrder S; S.init(M, 2 * FF, G, bx);
        pg8::EpiSwiGLU E{Hg, FF, P2};
        pg8::gemm_phase<pg8::EpiSwiGLU, pg8::StaticOrder, PG8_ALIGN, PG8_SP2>(ldsl + RING_OFF, g, S, E);
    }
    SEAM(6);
    if (IN(7)) {
        pg8::Gemm g{Hg, W2D, M, D, FF}; pg8::StaticOrder S; S.init(M, D, G, bx);
        pg8::EpiRes E{out, out, nullptr, nullptr, P3, 0.5f};
        pg8::gemm_phase<pg8::EpiRes, pg8::StaticOrder, PG8_ALIGN, PG8_SP2>(ldsl + RING_OFF, g, S, E);
    }
    SEAM(7);
    if (IN(8)) {
        f32x4 gg[4];
#pragma unroll
        for (int j = 0; j < 4; ++j) gg[j] = *((const f32x4*)g_final + lane + 64 * j);
        for (int m = gw; m < M; m += NGW) {
            const float pv = P3[(size_t)m * 16 + (lane & 15)];
            float s = pv; s += __shfl_xor(s, 1); s += __shfl_xor(s, 2); s += __shfl_xor(s, 4); s += __shfl_xor(s, 8);
            const float r = __builtin_amdgcn_rsqf(s * (1.0f / 1024.0f) + pg8::RMS_EPS);
            f32x4* xr = (f32x4*)(out + (size_t)m * D) + lane;
#pragma unroll
            for (int j = 0; j < 4; ++j) xr[64 * j] = xr[64 * j] * r * gg[j];
        }
    }
#undef IN
#undef SEAM
}

extern "C" void kernel_launch(void* const* d_in, const int* in_sizes, int n_in, void* d_out, int out_size, void* d_ws, size_t ws_size, hipStream_t stream) {
    static int grid = 0;
    if (grid == 0) {
        if (n_in != 20 || in_sizes[0] != M * D || out_size != M * D || ws_size < WS_END) { fprintf(stderr, "kernel_launch: unexpected shapes (n_in %d, in0 %d, out %d, ws %zu)\n", n_in, n_in > 0 ? in_sizes[0] : -1, out_size, ws_size); grid = -1; return; }
        int dev = 0, cus = 0, per_cu = 0;
        if (hipGetDevice(&dev) != hipSuccess || hipDeviceGetAttribute(&cus, hipDeviceAttributeMultiprocessorCount, dev) != hipSuccess) { grid = -1; return; }
        if (hipFuncSetAttribute((const void*)mk_fwd, hipFuncAttributeMaxDynamicSharedMemorySize, LDS_BYTES) != hipSuccess) { fprintf(stderr, "kernel_launch: hipFuncSetAttribute failed\n"); grid = -1; return; }
        if (hipOccupancyMaxActiveBlocksPerMultiprocessor(&per_cu, (const void*)mk_fwd, NWAVES * 64, LDS_BYTES) != hipSuccess || per_cu < 1) { fprintf(stderr, "kernel_launch: occupancy query says %d\n", per_cu); per_cu = 1; }
        (void)hipGetLastError();
        grid = cus * 1;
    }
    if (grid < 0) return;
    Args a{};
    for (int i = 0; i < 20; ++i) a.in[i] = (const float*)d_in[i];
    a.out = (float*)d_out; a.ws = (unsigned char*)d_ws;
    if (N_LAUNCHES == 1) {
        a.ph_lo = 0; a.ph_hi = N_PHASES;
        void* kargs[] = {&a};
        const hipError_t e = hipLaunchCooperativeKernel((const void*)mk_fwd, dim3(grid), dim3(NWAVES * 64), kargs, LDS_BYTES, stream);
        if (e != hipSuccess) fprintf(stderr, "kernel_launch: cooperative launch failed: %s (grid %d)\n", hipGetErrorString(e), grid);
    } else {
        for (int li = 0; li < N_PHASES; ++li) { a.ph_lo = li; a.ph_hi = li + 1;
            hipLaunchKernelGGL(mk_fwd, dim3(grid), dim3(NWAVES * 64), LDS_BYTES, stream, a); }
    }
}
```
